# Optimizing an MI355X kernel written in HIP

```python
import math
import jax, jax.numpy as jnp
from jax import lax
import numpy as np

D_MODEL = 1024
BATCH = 16
SEQ = 2048
DEPTH = 2

PLE_DIM = 256
Q_BLOCK = 128
RNN_WIDTH = 512
RNN_BLOCKS = 8
CONV_WIDTH = 4
LRU_C = 8.0
DSA_HEADS = 8
DSA_HEAD_DIM = 64
IDX_HEADS = 4
IDX_DIM = 64
DSA_TOPK_MAX = 256
MLA_HEADS = 16
MLA_Q_LORA = 512
MLA_KV_LORA = 256
MLA_NOPE = 64
MLA_ROPE = 32
MLA_V = 64
ROPE_BASE = 10000.0
D_FF = 4 * D_MODEL
DN_ALPHA = (2 * DEPTH) ** 0.25
DN_BETA = (8 * DEPTH) ** -0.25
LN_EPS = 1e-5
RMS_EPS = 1e-6
N_EVEN = (DEPTH + 1) // 2
N_ODD = DEPTH // 2
EVEN_SPLITS = (RNN_WIDTH, RNN_WIDTH, DSA_HEADS * DSA_HEAD_DIM, DSA_HEAD_DIM, DSA_HEAD_DIM,
               IDX_HEADS * IDX_DIM, IDX_DIM, IDX_HEADS)
EVEN_IN = sum(EVEN_SPLITS)
EVEN_MIX = RNN_WIDTH + DSA_HEADS * DSA_HEAD_DIM
MLA_DOWN = MLA_Q_LORA + MLA_KV_LORA + MLA_ROPE
MLA_MIX = MLA_HEADS * MLA_V

kernel_name = "hybrid_rglru_dsa_mla_deepnorm"


def layer_norm(x, g, b):
    xf = x.astype(jnp.float32)
    mu = jnp.mean(xf, axis=-1, keepdims=True)
    var = jnp.mean(jnp.square(xf - mu), axis=-1, keepdims=True)
    y = (xf - mu) * lax.rsqrt(var + LN_EPS) * g.astype(jnp.float32) + b.astype(jnp.float32)
    return y.astype(x.dtype)


def rms_norm(x, g):
    xf = x.astype(jnp.float32)
    y = xf * lax.rsqrt(jnp.mean(jnp.square(xf), axis=-1, keepdims=True) + RMS_EPS)
    return (y * g.astype(jnp.float32)).astype(x.dtype)


def causal_depthwise_conv(x, w, b):
    c = x.shape[-1]
    y = lax.conv_general_dilated(x, w[:, None, :], window_strides=(1,), padding=[(CONV_WIDTH - 1, 0)],
                                 dimension_numbers=("NWC", "WIO", "NWC"), feature_group_count=c)
    return y + b


def rg_lru(x, w_a, b_a, w_x, b_x, lam):
    bsz, s, c = x.shape
    xb = x.reshape(bsz, s, RNN_BLOCKS, c // RNN_BLOCKS)
    r = jax.nn.sigmoid(jnp.einsum("bsnc,ncd->bsnd", xb, w_a).reshape(bsz, s, c) + b_a)
    i = jax.nn.sigmoid(jnp.einsum("bsnc,ncd->bsnd", xb, w_x).reshape(bsz, s, c) + b_x)
    log_a = -LRU_C * r.astype(jnp.float32) * jax.nn.softplus(-lam.astype(jnp.float32))
    a = jnp.exp(log_a)
    u = jnp.sqrt(-jnp.expm1(2.0 * log_a)) * (i * x).astype(jnp.float32)

    def combine(left, right):
        a1, b1 = left
        a2, b2 = right
        return a1 * a2, a2 * b1 + b2

    _, h = lax.associative_scan(combine, (a, u), axis=1)
    return h.astype(x.dtype)


def alibi_slopes(n):
    return jnp.exp2(-8.0 * (jnp.arange(n, dtype=jnp.float32) + 1.0) / n)


def rope(x, cos, sin):
    half = x.shape[-1] // 2
    x1, x2 = x[..., :half], x[..., half:]
    return jnp.concatenate([x1 * cos - x2 * sin, x2 * cos + x1 * sin], axis=-1)


def to_blocks(a, nb):
    a = a.reshape((a.shape[0], nb, Q_BLOCK) + a.shape[2:])
    return jnp.moveaxis(a, 1, 0)


def from_blocks(o):
    o = jnp.moveaxis(o, 0, 1)
    return o.reshape((o.shape[0], o.shape[1] * o.shape[2]) + o.shape[3:])


def gather_rows(src, idx):
    return jax.vmap(lambda sb, ib: sb[ib])(src, idx)


def dsa_attention(q, k, v, iq, ik, iw):
    bsz, s = q.shape[:2]
    nb = s // Q_BLOCK
    topk = min(DSA_TOPK_MAX, s // 4)
    slopes = alibi_slopes(DSA_HEADS)
    key_pos = jnp.arange(s, dtype=jnp.int32)
    iw = iw.astype(jnp.float32) * (IDX_HEADS ** -0.5 * IDX_DIM ** -0.5)

    def block(args):
        qb, iqb, iwb, t0 = args
        qpos = t0 + jnp.arange(Q_BLOCK, dtype=jnp.int32)
        dots = jnp.einsum("bthd,bsd->bths", iqb, ik).astype(jnp.float32)
        isc = jnp.einsum("bths,bth->bts", jax.nn.relu(dots), iwb)
        causal = key_pos[None, :] <= qpos[:, None]
        isc = jnp.where(causal[None], isc, -jnp.inf)
        _, idx = lax.top_k(isc, topk)
        ksel = gather_rows(k, idx)
        vsel = gather_rows(v, idx)
        logits = jnp.einsum("bthd,btkd->bthk", qb, ksel).astype(jnp.float32) * (DSA_HEAD_DIM ** -0.5)
        dist = qpos[None, :, None] - idx
        logits = logits - slopes[None, None, :, None] * dist.astype(jnp.float32)[:, :, None, :]
        logits = jnp.where((dist >= 0)[:, :, None, :], logits, -jnp.inf)
        probs = jax.nn.softmax(logits, axis=-1).astype(v.dtype)
        return jnp.einsum("bthk,btkd->bthd", probs, vsel)

    starts = jnp.arange(nb, dtype=jnp.int32) * Q_BLOCK
    out = lax.map(block, (to_blocks(q, nb), to_blocks(iq, nb), to_blocks(iw, nb), starts))
    return from_blocks(out)


def mla_attention(q, k, v):
    bsz, s = q.shape[:2]
    nb = s // Q_BLOCK
    scale = q.shape[-1] ** -0.5
    key_pos = jnp.arange(s, dtype=jnp.int32)

    def block(args):
        qb, t0 = args
        qpos = t0 + jnp.arange(Q_BLOCK, dtype=jnp.int32)
        logits = jnp.einsum("bthd,bshd->bhts", qb, k).astype(jnp.float32) * scale
        causal = key_pos[None, :] <= qpos[:, None]
        logits = jnp.where(causal[None, None], logits, -jnp.inf)
        probs = jax.nn.softmax(logits, axis=-1).astype(v.dtype)
        return jnp.einsum("bhts,bshd->bthd", probs, v)

    starts = jnp.arange(nb, dtype=jnp.int32) * Q_BLOCK
    out = lax.map(block, (to_blocks(q, nb), starts))
    return from_blocks(out)


def hybrid_mixer(x, w_in, conv_w, conv_b, ga_w, ga_b, gx_w, gx_b, lam, w_out):
    bsz, s, _ = x.shape
    proj = x @ w_in
    split_points = np.cumsum(EVEN_SPLITS)[:-1].tolist()
    xr, yr, q, k, v, iq, ik, iw = jnp.split(proj, split_points, axis=-1)
    xr = causal_depthwise_conv(xr, conv_w, conv_b)
    rec = rg_lru(xr, ga_w, ga_b, gx_w, gx_b, lam) * jax.nn.gelu(yr)
    att = dsa_attention(q.reshape(bsz, s, DSA_HEADS, DSA_HEAD_DIM), k, v,
                        iq.reshape(bsz, s, IDX_HEADS, IDX_DIM), ik, iw)
    mixed = jnp.concatenate([rec, att.reshape(bsz, s, DSA_HEADS * DSA_HEAD_DIM)], axis=-1)
    return mixed @ w_out


def mla_mixer(x, w_down, q_norm, kv_norm, w_uq, w_ukv, w_out):
    bsz, s, _ = x.shape
    down = x @ w_down
    cq, ckv, kr = jnp.split(down, [MLA_Q_LORA, MLA_Q_LORA + MLA_KV_LORA], axis=-1)
    q = (rms_norm(cq, q_norm) @ w_uq).reshape(bsz, s, MLA_HEADS, MLA_NOPE + MLA_ROPE)
    kv = (rms_norm(ckv, kv_norm) @ w_ukv).reshape(bsz, s, MLA_HEADS, MLA_NOPE + MLA_V)
    q_nope, q_rope = q[..., :MLA_NOPE], q[..., MLA_NOPE:]
    k_nope, v = kv[..., :MLA_NOPE], kv[..., MLA_NOPE:]
    pos = jnp.arange(s, dtype=jnp.float32)
    freq = ROPE_BASE ** (-jnp.arange(0, MLA_ROPE, 2, dtype=jnp.float32) / MLA_ROPE)
    ang = pos[:, None] * freq[None, :]
    cos = jnp.cos(ang).astype(x.dtype)
    sin = jnp.sin(ang).astype(x.dtype)
    q_rope = rope(q_rope, cos[:, None, :], sin[:, None, :])
    k_rope = rope(kr, cos, sin)
    qf = jnp.concatenate([q_nope, q_rope], axis=-1)
    kf = jnp.concatenate([k_nope, jnp.broadcast_to(k_rope[:, :, None, :], (bsz, s, MLA_HEADS, MLA_ROPE))], axis=-1)
    o = mla_attention(qf, kf, v)
    return o.reshape(bsz, s, MLA_MIX) @ w_out


def setup_inputs(seed: int = 0) -> dict:
    key = jax.random.key(seed)
    ks = jax.random.split(key, 32)

    def nrm(k, shape, scale):
        return jax.random.normal(k, shape, jnp.float32) * scale

    u = jax.random.uniform(ks[12], (N_EVEN, RNN_WIDTH), jnp.float32, 0.9, 0.999)
    sig = u ** (1.0 / LRU_C)
    lam = jnp.log(sig) - jnp.log1p(-sig)
    bw = RNN_WIDTH // RNN_BLOCKS
    return {
        "x": nrm(ks[0], (BATCH, SEQ, D_MODEL), 1.0),
        "p": nrm(ks[1], (DEPTH, BATCH, SEQ, PLE_DIM), 1.0),
        "ln1_g": 1.0 + nrm(ks[2], (DEPTH, D_MODEL), 0.02),
        "ln1_b": nrm(ks[3], (DEPTH, D_MODEL), 0.02),
        "ln2_g": 1.0 + nrm(ks[4], (DEPTH, D_MODEL), 0.02),
        "ln2_b": nrm(ks[5], (DEPTH, D_MODEL), 0.02),
        "mlp_w1": nrm(ks[6], (DEPTH, D_MODEL, D_FF), D_MODEL ** -0.5),
        "mlp_w2": nrm(ks[7], (DEPTH, D_FF, D_MODEL), DN_BETA * D_FF ** -0.5),
        "ple_w_proj": nrm(ks[8], (DEPTH, PLE_DIM, D_MODEL), DN_BETA * PLE_DIM ** -0.5),
        "ple_w_gate": nrm(ks[9], (DEPTH, D_MODEL, D_MODEL), D_MODEL ** -0.5),
        "hy_w_in": nrm(ks[10], (N_EVEN, D_MODEL, EVEN_IN), D_MODEL ** -0.5),
        "hy_conv_w": nrm(ks[11], (N_EVEN, CONV_WIDTH, RNN_WIDTH), CONV_WIDTH ** -0.5),
        "hy_conv_b": nrm(ks[13], (N_EVEN, RNN_WIDTH), 0.01),
        "hy_ga_w": nrm(ks[14], (N_EVEN, RNN_BLOCKS, bw, bw), bw ** -0.5),
        "hy_ga_b": nrm(ks[15], (N_EVEN, RNN_WIDTH), 0.01),
        "hy_gx_w": nrm(ks[16], (N_EVEN, RNN_BLOCKS, bw, bw), bw ** -0.5),
        "hy_gx_b": nrm(ks[17], (N_EVEN, RNN_WIDTH), 0.01),
        "hy_lambda": lam,
        "hy_w_out": nrm(ks[18], (N_EVEN, EVEN_MIX, D_MODEL), DN_BETA * EVEN_MIX ** -0.5),
        "mla_w_down": nrm(ks[19], (N_ODD, D_MODEL, MLA_DOWN), D_MODEL ** -0.5),
        "mla_q_norm": 1.0 + nrm(ks[20], (N_ODD, MLA_Q_LORA), 0.02),
        "mla_kv_norm": 1.0 + nrm(ks[21], (N_ODD, MLA_KV_LORA), 0.02),
        "mla_w_uq": nrm(ks[22], (N_ODD, MLA_Q_LORA, MLA_HEADS * (MLA_NOPE + MLA_ROPE)), MLA_Q_LORA ** -0.5),
        "mla_w_ukv": nrm(ks[23], (N_ODD, MLA_KV_LORA, MLA_HEADS * (MLA_NOPE + MLA_V)), MLA_KV_LORA ** -0.5),
        "mla_w_out": nrm(ks[24], (N_ODD, MLA_MIX, D_MODEL), DN_BETA * MLA_MIX ** -0.5),
    }


def reference(x, p, ln1_g, ln1_b, ln2_g, ln2_b, mlp_w1, mlp_w2, ple_w_proj, ple_w_gate,
              hy_w_in, hy_conv_w, hy_conv_b, hy_ga_w, hy_ga_b, hy_gx_w, hy_gx_b, hy_lambda, hy_w_out,
              mla_w_down, mla_q_norm, mla_kv_norm, mla_w_uq, mla_w_ukv, mla_w_out):
    for i in range(DEPTH):
        j = i // 2
        if i % 2 == 0:
            m = hybrid_mixer(x, hy_w_in[j], hy_conv_w[j], hy_conv_b[j], hy_ga_w[j], hy_ga_b[j],
                             hy_gx_w[j], hy_gx_b[j], hy_lambda[j], hy_w_out[j])
        else:
            m = mla_mixer(x, mla_w_down[j], mla_q_norm[j], mla_kv_norm[j], mla_w_uq[j],
                          mla_w_ukv[j], mla_w_out[j])
        h = layer_norm(DN_ALPHA * x + m, ln1_g[i], ln1_b[i])
        f = jnp.square(jax.nn.relu(h @ mlp_w1[i])) @ mlp_w2[i]
        e = jax.nn.sigmoid(h @ ple_w_gate[i]) * (p[i] @ ple_w_proj[i])
        x = layer_norm(DN_ALPHA * h + f + e, ln2_g[i], ln2_b[i])
    return x
```

```cpp
#include <hip/hip_runtime.h>
#include <cstdio>
#include <cstdint>
#include <cmath>

#define LAS __attribute__((address_space(3)))
#define GAS __attribute__((address_space(1)))
typedef unsigned short bf16_t;
typedef short bf16x8 __attribute__((ext_vector_type(8)));
typedef short s16x4 __attribute__((ext_vector_type(4)));
typedef float f32x4 __attribute__((ext_vector_type(4)));
typedef float f32x2 __attribute__((ext_vector_type(2)));
typedef float f32x16 __attribute__((ext_vector_type(16)));
typedef unsigned u32x4 __attribute__((ext_vector_type(4)));
typedef unsigned u32x2 __attribute__((ext_vector_type(2)));
typedef __bf16 bf16x2_t __attribute__((ext_vector_type(2)));

#ifndef MK_SPLIT
#define MK_SPLIT 0
#endif

constexpr int TOK = 32768, SEQ = 2048, NBATCH = 16, DM = 1024, DFF = 4096, HALF_TOK = TOK / 2;
constexpr float DN_ALPHA = 1.41421356237309515f;
constexpr float LOG2E = 1.4426950408889634f;
constexpr float C2_DSA = 0.125f * LOG2E;
constexpr float C2_MLA = 0.14724445f;

__device__ __forceinline__ unsigned pk2(float lo, float hi) { f32x2 v = {lo, hi}; bf16x2_t b = __builtin_convertvector(v, bf16x2_t); return __builtin_bit_cast(unsigned, b); }
__device__ __forceinline__ float bflo(unsigned w) { return __uint_as_float(w << 16); }
__device__ __forceinline__ float bfhi(unsigned w) { return __uint_as_float(w & 0xffff0000u); }
__device__ __forceinline__ float bf2f(bf16_t h) { return __uint_as_float((unsigned)h << 16); }
__device__ __forceinline__ float wave_sum(float v) {
#pragma unroll
    for (int o = 1; o < 64; o <<= 1) v += __shfl_xor(v, o);
    return v;
}
__device__ __forceinline__ float fsigmoid(float x) { return __builtin_amdgcn_rcpf(1.0f + __builtin_amdgcn_exp2f(-x * LOG2E)); }
__device__ __forceinline__ float gelu_tanh(float y) {
    const float w = 0.7978845608028654f * (y + 0.044715f * y * y * y);
    const float e = __builtin_amdgcn_exp2f(2.0f * LOG2E * w);
    const float th = 1.0f - 2.0f * __builtin_amdgcn_rcpf(e + 1.0f);
    return 0.5f * y * (1.0f + th);
}

namespace pg8 {
constexpr int BM = 256, BK = 64, HALF = 128, HTB = HALF * BK * 2, STAGE_BYTES = 8 * HTB, NXCD = 8, WGM = 8;
__host__ __device__ __forceinline__ int lds_byte(int r, int c) { const int st = (r >> 4) * 2 + (c >> 5), rr = r & 15, cc = c & 31, ob = rr * 64 + cc * 2; return st * 1024 + (ob ^ (((ob >> 9) & 1) << 5)); }
__host__ __device__ __forceinline__ void stage_rc(int b, int& R, int& C) { const int st = b / 1024, sb = b % 1024, swz = sb ^ (((sb >> 9) & 1) << 5); R = (st >> 1) * 16 + swz / 64; C = (st & 1) * 32 + (swz % 64) / 2; }
__host__ __device__ __forceinline__ int perm32(int rho) { const int n = rho >> 4, i = rho & 15; return 8 * (i >> 2) + 4 * n + (i & 3); }
struct Unit { int pm, pn; };
struct Gemm { const bf16_t* A; const bf16_t* Bt; int M, N, K, lda; };
struct StaticOrder {
    int nM, nN, nwg, G, c;
    __host__ __device__ void init(int M, int N, int G_, int c_) { nM = M / BM; nN = N / BM; nwg = nM * nN; G = G_; c = c_; }
    __host__ __device__ bool next(int i, Unit& u) const {
        const long L = (long)i * G + c; if (L >= nwg) return false;
        int wgid = (int)L; { const int q = nwg / NXCD, r = nwg % NXCD, xcd = wgid % NXCD, off = wgid / NXCD; wgid = (xcd < r ? xcd * (q + 1) : r * (q + 1) + (xcd - r) * q) + off; }
        const int nig = WGM * nN, gid = wgid / nig, fm = gid * WGM, gsz = (nM - fm) < WGM ? (nM - fm) : WGM;
        u.pm = fm + ((wgid % nig) % gsz); u.pn = (wgid % nig) / gsz; return true;
    }
    __device__ __forceinline__ void a_ready(const Unit&) const {}
    __device__ __forceinline__ void done(const Unit&) const {}
};

template <class Epi, class Sched, bool ALIGN_EPI = false, bool SP2 = false>
__device__ __forceinline__ void gemm_phase(const int tid, LAS unsigned char* lds, const Gemm g, const Sched& S, const Epi& E) {
    const int wid = __builtin_amdgcn_readfirstlane(tid >> 6), lane = tid & 63, wr = wid >> 2, wc = wid & 3, fr = lane & 15, fq = lane >> 4;
    int K = g.K; asm volatile("" : "+s"(K));
    const int nt = K / BK;
    int lda = g.lda; asm volatile("" : "+s"(lda));
    unsigned voffA[2], voffB[2];
#pragma unroll
    for (int i = 0; i < 2; ++i) { int R, C; stage_rc(tid * 16 + i * 8192, R, C); const int Rb = Epi::PERM ? ((R & ~31) + perm32(R & 31)) : R;
        voffA[i] = (unsigned)(R * lda + C) * 2u; voffB[i] = (unsigned)(Rb * K + C) * 2u; }
    const size_t kstep = (size_t)(BK * 2);
    const size_t hstepB = (size_t)HALF * K * 2, hstepA = (size_t)HALF * lda * 2;
    const size_t tstepB = 2 * hstepB, tstepA = 2 * hstepA;
    const unsigned ldsw = (unsigned)wid * 1024u;
    const int aoff = lds_byte(wr * 64 + fr, fq * 8), boff = lds_byte(wc * 32 + fr, fq * 8);
#define PG8_SA(b, h) (((b) * 2 + (h)) * HTB)
#define PG8_SB(b, h) ((4 + (b) * 2 + (h)) * HTB)
#define PG8_STAGE(bufoff, gbase, voff) do { _Pragma("unroll") for (int _i = 0; _i < 2; ++_i) \
        __builtin_amdgcn_global_load_lds((const unsigned*)((const char*)(gbase) + (voff)[_i]), (LAS unsigned*)(lds + (bufoff) + ldsw + _i * 8192), 16, 0, 0); } while (0)
#define PG8_LDA(dst, b, h) do { _Pragma("unroll") for (int m = 0; m < 4; ++m) _Pragma("unroll") for (int k = 0; k < 2; ++k) dst[m][k] = *(const LAS bf16x8*)(lds + PG8_SA(b, h) + aoff + m * 2048 + k * 1024); } while (0)
#define PG8_LDB(dst, b, h) do { _Pragma("unroll") for (int n = 0; n < 2; ++n) _Pragma("unroll") for (int k = 0; k < 2; ++k) dst[n][k] = *(const LAS bf16x8*)(lds + PG8_SB(b, h) + boff + n * 2048 + k * 1024); } while (0)
#define PG8_MMA(ai, bj, At, Bt) do { __builtin_amdgcn_s_setprio(1); _Pragma("unroll") for (int m = 0; m < 4; ++m) _Pragma("unroll") for (int n = 0; n < 2; ++n) _Pragma("unroll") for (int k = 0; k < 2; ++k) \
        acc[ai][bj][m][n] = __builtin_amdgcn_mfma_f32_16x16x32_bf16(Bt[n][k], At[m][k], acc[ai][bj][m][n], 0, 0, 0); __builtin_amdgcn_s_setprio(0); } while (0)
#define PG8_WAIT_V(n) asm volatile("s_waitcnt vmcnt(" #n ")" ::: "memory")
#define PG8_WAIT_L(n) asm volatile("s_waitcnt lgkmcnt(" #n ")" ::: "memory")
#define PG8_BAR __builtin_amdgcn_s_barrier()
#define PG8_SCHED __builtin_amdgcn_sched_barrier(0)
    Unit cur, nxt; int ui = 0;
    if (!S.next(0, cur)) return;
    f32x4 acc[2][2][4][2];
#pragma unroll
    for (int a = 0; a < 2; ++a)
#pragma unroll
        for (int b = 0; b < 2; ++b)
#pragma unroll
            for (int m = 0; m < 4; ++m)
#pragma unroll
                for (int n = 0; n < 2; ++n) acc[a][b][m][n] = (f32x4){0.f, 0.f, 0.f, 0.f};
    bf16x8 At[4][2], B0[2][2], B1[2][2];
    const char* cA = (const char*)g.A + (size_t)cur.pm * tstepA; const char* cB = (const char*)g.Bt + (size_t)cur.pn * tstepB;
    S.a_ready(cur);
    if constexpr (SP2) {
        PG8_STAGE(PG8_SB(0, 0), cB, voffB); PG8_STAGE(PG8_SB(0, 1), cB + hstepB, voffB); PG8_STAGE(PG8_SA(0, 0), cA, voffA); PG8_STAGE(PG8_SA(0, 1), cA + hstepA, voffA);
        if (wr == 1) PG8_BAR;
        PG8_WAIT_V(2); PG8_BAR;
        PG8_STAGE(PG8_SB(1, 0), cB + kstep, voffB); PG8_STAGE(PG8_SA(1, 0), cA + kstep, voffA); PG8_STAGE(PG8_SB(1, 1), cB + hstepB + kstep, voffB);
        PG8_WAIT_V(6); PG8_BAR;
    } else {
        PG8_STAGE(PG8_SB(0, 0), cB, voffB); PG8_STAGE(PG8_SA(0, 0), cA, voffA); PG8_STAGE(PG8_SB(0, 1), cB + hstepB, voffB); PG8_STAGE(PG8_SA(0, 1), cA + hstepA, voffA);
        if (wr == 1) PG8_BAR;
        PG8_WAIT_V(4); PG8_BAR;
        PG8_STAGE(PG8_SB(1, 0), cB + kstep, voffB); PG8_STAGE(PG8_SA(1, 0), cA + kstep, voffA); PG8_STAGE(PG8_SB(1, 1), cB + hstepB + kstep, voffB);
        PG8_WAIT_V(6); PG8_BAR;
    }
    for (;;) {
        const bool has_next = S.next(ui + 1, nxt);
        const char* nA = has_next ? (const char*)g.A + (size_t)nxt.pm * tstepA : cA; const char* nB = has_next ? (const char*)g.Bt + (size_t)nxt.pn * tstepB : cB;
        for (int t = 0; t < nt; t += 2) {
            const bool last = (t == nt - 2);
            const char* a1 = cA + (size_t)(t + 1) * kstep;
            const char* a2 = last ? nA : cA + (size_t)(t + 2) * kstep; const char* b2 = last ? nB : cB + (size_t)(t + 2) * kstep;
            const char* a3 = a2 + kstep; const char* b3 = b2 + kstep;
            if (last && has_next) S.a_ready(nxt);
            if constexpr (SP2) {
            PG8_LDB(B0, 0, 0); PG8_LDB(B1, 0, 1); PG8_SCHED; PG8_LDA(At, 0, 0); PG8_STAGE(PG8_SA(1, 1), a1 + hstepA, voffA);
            PG8_WAIT_V(8); PG8_WAIT_L(0); PG8_BAR; PG8_MMA(0, 0, At, B0); PG8_MMA(0, 1, At, B1); PG8_BAR; PG8_SCHED;
            PG8_LDA(At, 0, 1); PG8_STAGE(PG8_SB(0, 0), b2, voffB); PG8_STAGE(PG8_SB(0, 1), b2 + hstepB, voffB); PG8_STAGE(PG8_SA(0, 0), a2, voffA);
            PG8_WAIT_V(8); PG8_WAIT_L(0); PG8_BAR; PG8_MMA(1, 0, At, B0); PG8_MMA(1, 1, At, B1); PG8_BAR; PG8_SCHED;
            PG8_LDB(B0, 1, 0); PG8_LDB(B1, 1, 1); PG8_SCHED; PG8_LDA(At, 1, 0); PG8_STAGE(PG8_SA(0, 1), a2 + hstepA, voffA);
            PG8_WAIT_V(8); PG8_WAIT_L(0); PG8_BAR; PG8_MMA(0, 0, At, B0); PG8_MMA(0, 1, At, B1); PG8_BAR; PG8_SCHED;
            PG8_LDA(At, 1, 1); PG8_STAGE(PG8_SB(1, 0), b3, voffB); PG8_STAGE(PG8_SB(1, 1), b3 + hstepB, voffB); PG8_STAGE(PG8_SA(1, 0), a3, voffA);
            PG8_WAIT_V(8); PG8_WAIT_L(0); PG8_BAR; PG8_MMA(1, 0, At, B0); PG8_MMA(1, 1, At, B1); PG8_BAR; PG8_SCHED;
            } else {
            PG8_LDB(B0, 0, 0); PG8_SCHED; PG8_LDA(At, 0, 0); PG8_STAGE(PG8_SA(1, 1), a1 + hstepA, voffA);
            PG8_WAIT_L(8); PG8_BAR; PG8_WAIT_L(0); PG8_MMA(0, 0, At, B0); PG8_BAR; PG8_SCHED;
            PG8_LDB(B1, 0, 1); PG8_STAGE(PG8_SB(0, 0), b2, voffB);
            PG8_BAR; PG8_WAIT_L(0); PG8_MMA(0, 1, At, B1); PG8_BAR;
            PG8_LDA(At, 0, 1); PG8_STAGE(PG8_SA(0, 0), a2, voffA);
            PG8_BAR; PG8_WAIT_L(0); PG8_MMA(1, 0, At, B0); PG8_BAR; PG8_SCHED;
            PG8_STAGE(PG8_SB(0, 1), b2 + hstepB, voffB);
            PG8_WAIT_V(6); PG8_BAR; PG8_MMA(1, 1, At, B1); PG8_BAR;
            PG8_LDB(B0, 1, 0); PG8_SCHED; PG8_LDA(At, 1, 0); PG8_STAGE(PG8_SA(0, 1), a2 + hstepA, voffA);
            PG8_WAIT_L(8); PG8_BAR; PG8_WAIT_L(0); PG8_MMA(0, 0, At, B0); PG8_BAR; PG8_SCHED;
            PG8_LDB(B1, 1, 1); PG8_STAGE(PG8_SB(1, 0), b3, voffB);
            PG8_BAR; PG8_WAIT_L(0); PG8_MMA(0, 1, At, B1); PG8_BAR;
            PG8_LDA(At, 1, 1); PG8_STAGE(PG8_SA(1, 0), a3, voffA);
            PG8_BAR; PG8_WAIT_L(0); PG8_MMA(1, 0, At, B0); PG8_BAR; PG8_SCHED;
            PG8_STAGE(PG8_SB(1, 1), b3 + hstepB, voffB);
            PG8_WAIT_V(6); PG8_BAR; PG8_MMA(1, 1, At, B1); PG8_BAR;
            }
        }
        if constexpr (ALIGN_EPI) { if (wr == 0) PG8_BAR; }
        E(acc, cur, wr, wc, fr, fq); S.done(cur);
        if (!has_next) break;
#pragma unroll
        for (int a = 0; a < 2; ++a)
#pragma unroll
            for (int b = 0; b < 2; ++b)
#pragma unroll
                for (int m = 0; m < 4; ++m)
#pragma unroll
                    for (int n = 0; n < 2; ++n) acc[a][b][m][n] = (f32x4){0.f, 0.f, 0.f, 0.f};
        cur = nxt; cA = nA; cB = nB; ++ui;
        if constexpr (ALIGN_EPI) { if (wr == 1) PG8_BAR; }
    }
    PG8_WAIT_V(0);
    if constexpr (!ALIGN_EPI) { if (wr == 0) PG8_BAR; }
    PG8_BAR;
#undef PG8_SA
#undef PG8_SB
#undef PG8_STAGE
#undef PG8_LDA
#undef PG8_LDB
#undef PG8_MMA
#undef PG8_WAIT_V
#undef PG8_WAIT_L
#undef PG8_BAR
#undef PG8_SCHED
}

typedef f32x4 AccT[2][2][4][2];
template <int ACT, int ROUTE, int SCALE> struct EpiBf {
    static constexpr bool PERM = true, AFTER_DRAIN = false;
    bf16_t* O; int ldc; bf16_t *O1, *O2, *O3; const float* SSQ;
    __device__ __forceinline__ void operator()(const AccT& acc, const Unit& u, int wr, int wc, int fr, int fq) const {
        int colt = u.pn * BM; bf16_t* base = O; int ld = ldc;
        if (ROUTE == 1) { if (u.pn < 4) {} else if (u.pn < 6) { base = O1; ld = 512; colt -= 1024; } else if (u.pn == 6) { base = O2; ld = 256; colt = 0; } else { base = O3; ld = 256; colt = 0; } }
        const int row0 = u.pm * BM + wr * 64 + fr, col0 = colt + wc * 32 + 8 * fq;
#pragma unroll
        for (int ai = 0; ai < 2; ++ai)
#pragma unroll
            for (int m = 0; m < 4; ++m) {
                const int row = row0 + ai * HALF + m * 16;
                bf16_t* rowp = base + (size_t)row * ld + col0;
                float sc = 1.f;
                if (SCALE == 1) { const f32x4 s4 = *(const f32x4*)(SSQ + (size_t)row * 16 + 8); sc = 1.0f / sqrtf(((s4[0] + s4[1]) + (s4[2] + s4[3])) * (1.0f / 256.0f) + 1e-6f); }
#pragma unroll
                for (int bj = 0; bj < 2; ++bj) {
                    f32x4 v0 = acc[ai][bj][m][0], v1 = acc[ai][bj][m][1];
                    if (ACT == 1) {
#pragma unroll
                        for (int i = 0; i < 4; ++i) { const float a = fmaxf(v0[i], 0.f), b = fmaxf(v1[i], 0.f); v0[i] = a * a; v1[i] = b * b; }
                    }
                    if (ACT == 2) {
                        const u32x4 old = *(const u32x4*)(rowp + bj * HALF);
                        v0[0] = fsigmoid(v0[0]) * bflo(old[0]); v0[1] = fsigmoid(v0[1]) * bfhi(old[0]); v0[2] = fsigmoid(v0[2]) * bflo(old[1]); v0[3] = fsigmoid(v0[3]) * bfhi(old[1]);
                        v1[0] = fsigmoid(v1[0]) * bflo(old[2]); v1[1] = fsigmoid(v1[1]) * bfhi(old[2]); v1[2] = fsigmoid(v1[2]) * bflo(old[3]); v1[3] = fsigmoid(v1[3]) * bfhi(old[3]);
                    }
                    if (SCALE == 1) { v0 = v0 * sc; v1 = v1 * sc; }
                    u32x4 w; w.x = pk2(v0[0], v0[1]); w.y = pk2(v0[2], v0[3]); w.z = pk2(v1[0], v1[1]); w.w = pk2(v1[2], v1[3]);
                    *(u32x4*)(rowp + bj * HALF) = w;
                }
                if (ACT == 2 || SCALE == 1) asm volatile("" ::: "memory");
            }
    }
};
struct EpiRes {
    static constexpr bool PERM = false, AFTER_DRAIN = false;
    const float* res; float* out; const bf16_t* E; float alpha;
    __device__ __forceinline__ void operator()(const AccT& acc, const Unit& u, int wr, int wc, int fr, int fq) const {
        const int row0 = u.pm * BM + wr * 64 + fr, col0 = u.pn * BM + wc * 32 + 4 * fq;
#pragma unroll
        for (int ai = 0; ai < 2; ++ai)
#pragma unroll
            for (int m = 0; m < 4; ++m) {
                const size_t off = (size_t)(row0 + ai * HALF + m * 16) * DM + col0;
#pragma unroll
                for (int bj = 0; bj < 2; ++bj)
#pragma unroll
                    for (int n = 0; n < 2; ++n) {
                        const size_t o = off + bj * HALF + n * 16;
                        const f32x4 r = *(const f32x4*)(res + o);
                        f32x4 v = r * alpha + acc[ai][bj][m][n];
                        if (E) { const u32x2 e = *(const u32x2*)(E + o); v[0] += bflo(e[0]); v[1] += bfhi(e[0]); v[2] += bflo(e[1]); v[3] += bfhi(e[1]); }
                        *(f32x4*)(out + o) = v;
                    }
                asm volatile("" ::: "memory");
            }
    }
};
struct EpiDown {
    static constexpr bool PERM = false, AFTER_DRAIN = false;
    bf16_t* DN; bf16_t* KR; float* SSQ; const float* ropeC; const float* ropeS;
    __device__ __forceinline__ void operator()(const AccT& acc, const Unit& u, int wr, int wc, int fr, int fq) const {
        const int row0 = u.pm * BM + wr * 64 + fr, col0 = u.pn * BM + wc * 32 + 4 * fq;
#pragma unroll
        for (int ai = 0; ai < 2; ++ai)
#pragma unroll
            for (int m = 0; m < 4; ++m) {
                const int row = row0 + ai * HALF + m * 16;
                if (u.pn < 3) {
                    float ss = 0.f;
#pragma unroll
                    for (int bj = 0; bj < 2; ++bj)
#pragma unroll
                        for (int n = 0; n < 2; ++n) { const f32x4 v = acc[ai][bj][m][n]; ss += (v[0] * v[0] + v[1] * v[1]) + (v[2] * v[2] + v[3] * v[3]);
                            u32x2 w; w.x = pk2(v[0], v[1]); w.y = pk2(v[2], v[3]); *(u32x2*)(DN + (size_t)row * DM + col0 + bj * HALF + n * 16) = w; }
                    ss += __shfl_xor(ss, 16); ss += __shfl_xor(ss, 32);
                    if (fq == 0) SSQ[(size_t)row * 16 + u.pn * 4 + wc] = ss;
                } else if (wc == 0) {
                    const f32x4 x1 = acc[ai][0][m][0], x2 = acc[ai][0][m][1];
                    const int pos = row & (SEQ - 1);
                    const f32x4 c = *(const f32x4*)(ropeC + pos * 16 + 4 * fq), s = *(const f32x4*)(ropeS + pos * 16 + 4 * fq);
                    const f32x4 o1 = x1 * c - x2 * s, o2 = x2 * c + x1 * s;
                    u32x2 w1, w2; w1.x = pk2(o1[0], o1[1]); w1.y = pk2(o1[2], o1[3]); w2.x = pk2(o2[0], o2[1]); w2.y = pk2(o2[2], o2[3]);
                    *(u32x2*)(KR + (size_t)row * 32 + 4 * fq) = w1; *(u32x2*)(KR + (size_t)row * 32 + 16 + 4 * fq) = w2;
                }
                asm volatile("" ::: "memory");
            }
    }
};
struct EpiUq {
    static constexpr bool PERM = false, AFTER_DRAIN = false;
    bf16_t* Q; const float* SSQ; const float* ropeC; const float* ropeS;
    __device__ __forceinline__ void operator()(const AccT& acc, const Unit& u, int wr, int wc, int fr, int fq) const {
        const int row0 = u.pm * BM + wr * 64 + fr;
#pragma unroll
        for (int ai = 0; ai < 2; ++ai)
#pragma unroll
            for (int m = 0; m < 4; ++m) {
                const int row = row0 + ai * HALF + m * 16;
                const f32x4 sa = *(const f32x4*)(SSQ + (size_t)row * 16), sb = *(const f32x4*)(SSQ + (size_t)row * 16 + 4);
                const float rstd = 1.0f / sqrtf((((sa[0] + sa[1]) + (sa[2] + sa[3])) + ((sb[0] + sb[1]) + (sb[2] + sb[3]))) * (1.0f / 512.0f) + 1e-6f);
                const int pos = row & (SEQ - 1);
#pragma unroll
                for (int bj = 0; bj < 2; ++bj) {
                    const int g = u.pn * 8 + bj * 4 + wc;
                    f32x4 x1 = acc[ai][bj][m][0] * rstd, x2 = acc[ai][bj][m][1] * rstd;
                    if (g % 3 == 2) {
                        const f32x4 c = *(const f32x4*)(ropeC + pos * 16 + 4 * fq), s = *(const f32x4*)(ropeS + pos * 16 + 4 * fq);
                        const f32x4 o1 = x1 * c - x2 * s, o2 = x2 * c + x1 * s; x1 = o1; x2 = o2;
                    }
                    u32x2 w1, w2; w1.x = pk2(x1[0], x1[1]); w1.y = pk2(x1[2], x1[3]); w2.x = pk2(x2[0], x2[1]); w2.y = pk2(x2[2], x2[3]);
                    bf16_t* p = Q + (size_t)row * 1536 + g * 32 + 4 * fq;
                    *(u32x2*)p = w1; *(u32x2*)(p + 16) = w2;
                }
                asm volatile("" ::: "memory");
            }
    }
};
}

namespace att {
typedef LAS const char* lds_cptr;
typedef short v4i16_t __attribute__((ext_vector_type(4)));
constexpr int KSLOT = 12288, VSLOT = 8192;
constexpr int L_K = 0, L_V = 2 * KSLOT, L_M = L_V + 2 * VSLOT, L_WS = L_M + 512, L_OST = L_WS + 8 * 256, L_END = L_OST + 8 * 4096;
__device__ __forceinline__ int crow(int r, int hi) { return (r & 3) + 8 * (r >> 2) + 4 * hi; }
__device__ __forceinline__ void glds16(const void* g, unsigned lds_dst) { unsigned keep;
    asm volatile("s_mov_b32 %0, m0\n\ts_mov_b32 m0, %2\n\ts_nop 0\n\tglobal_load_lds_dwordx4 %1, off\n\ts_mov_b32 m0, %0" : "=&s"(keep) : "v"(g), "s"(lds_dst) : "memory"); }
__device__ __forceinline__ void glds4(const void* g, unsigned lds_dst) { unsigned keep;
    asm volatile("s_mov_b32 %0, m0\n\ts_mov_b32 m0, %2\n\ts_nop 0\n\tglobal_load_lds_dword %1, off\n\ts_mov_b32 m0, %0" : "=&s"(keep) : "v"(g), "s"(lds_dst) : "memory"); }
#define ATT_WAIT_BAR() asm volatile("s_waitcnt vmcnt(0) lgkmcnt(0)\n\ts_barrier" ::: "memory")
__device__ __forceinline__ s16x4 vtr(lds_cptr p) { return __builtin_bit_cast(s16x4, __builtin_amdgcn_ds_read_tr16_b64_v4i16((LAS v4i16_t*)p)); }
__device__ __forceinline__ float half_max(float m) { auto rr = __builtin_amdgcn_permlane32_swap(__float_as_uint(m), __float_as_uint(m), false, false); return fmaxf(__uint_as_float(rr[0]), __uint_as_float(rr[1])); }
__device__ __forceinline__ float half_sum(float m) { auto rr = __builtin_amdgcn_permlane32_swap(__float_as_uint(m), __float_as_uint(m), false, false); return __uint_as_float(rr[0]) + __uint_as_float(rr[1]); }

struct AttnP { const bf16_t* Q; int qp; const bf16_t* K; int kp; const bf16_t* KR; const bf16_t* V; int vp; bf16_t* O; int op; const unsigned* MASK; };

template <int NCH, bool DSA>
__device__ __forceinline__ void attn_unit(const int tid, LAS unsigned char* lds, const AttnP& P, int b, int head, int q0, int nt) {
    const int lane = tid & 63, r32 = lane & 31, hi = lane >> 5; const int wid = __builtin_amdgcn_readfirstlane(tid >> 6);
    const long rowbase = (long)b * SEQ;
    const int wq0 = DSA ? q0 : q0 + 32 * wid;
    const int hq = DSA ? wid : head;
    const int qcol = DSA ? hq * 64 : hq * 96, kcol = DSA ? 0 : hq * 128, vcol = DSA ? 64 : hq * 128 + 64, ocol = hq * 64;
    const unsigned lds0 = (unsigned)(uintptr_t)lds;
    LAS float* wsf = (LAS float*)(lds + L_WS) + wid * 64;
    float slope2 = 0.f;
    if (DSA) slope2 = __builtin_amdgcn_exp2f(-(float)(hq + 1)) * LOG2E;
#define ATT_DMA(t, slot) do { const long kr_ = rowbase + 64 * (t); \
        glds16(P.K + (kr_ + lane) * P.kp + kcol + wid * 8, (unsigned)__builtin_amdgcn_readfirstlane(lds0 + L_K + (slot) * KSLOT + wid * 1024)); \
        if (NCH == 12 && wid < 4) glds16(P.KR + (kr_ + lane) * 32 + wid * 8, (unsigned)__builtin_amdgcn_readfirstlane(lds0 + L_K + (slot) * KSLOT + (8 + wid) * 1024)); \
        glds16(P.V + (kr_ + 16 * (wid & 3) + (lane >> 2)) * P.vp + vcol + (wid >> 2) * 32 + (lane & 3) * 8, (unsigned)__builtin_amdgcn_readfirstlane(lds0 + L_V + (slot) * VSLOT + wid * 1024)); \
        if (DSA && wid == 0) glds4(P.MASK + (rowbase + q0 + (lane >> 1)) * 64 + 2 * (t) + (lane & 1), (unsigned)__builtin_amdgcn_readfirstlane(lds0 + L_M + (slot) * 256)); } while (0)
    ATT_DMA(0, 0);
    bf16x8 qr[NCH / 2];
    { const bf16_t* Qw = P.Q + (rowbase + wq0 + r32) * P.qp + qcol + hi * 8;
#pragma unroll
      for (int d0 = 0; d0 < NCH / 2; ++d0) qr[d0] = *(const bf16x8*)(Qw + d0 * 16); }
    float m_run = -INFINITY, l_run = 0.f; f32x16 o0 = {}, o1 = {};
    const int qpos = wq0 + r32;
    for (int t = 0; t < nt; ++t) {
        ATT_WAIT_BAR();
        if (t + 1 < nt) ATT_DMA(t + 1, (t + 1) & 1);
        const int slot = t & 1;
        if (!DSA && 64 * t > wq0 + 31) continue;
        f32x16 p0, p1;
        if (DSA) {
            const float base = slope2 * (float)(64 * t + 4 * hi - qpos);
#pragma unroll
            for (int r = 0; r < 16; ++r) { p0[r] = base + slope2 * (float)((r & 3) + 8 * (r >> 2)); p1[r] = p0[r] + slope2 * 32.0f; }
        } else { p0 = f32x16{}; p1 = f32x16{}; }
        { const lds_cptr kb = (lds_cptr)lds + L_K + slot * KSLOT + hi * 1024 + r32 * 16;
#pragma unroll
          for (int d0 = 0; d0 < NCH / 2; ++d0) {
              const bf16x8 b0 = *(const LAS bf16x8*)(kb + d0 * 2048), b1 = *(const LAS bf16x8*)(kb + d0 * 2048 + 512);
              p0 = __builtin_amdgcn_mfma_f32_32x32x16_bf16(b0, qr[d0], p0, 0, 0, 0);
              p1 = __builtin_amdgcn_mfma_f32_32x32x16_bf16(b1, qr[d0], p1, 0, 0, 0); } }
        if (DSA) {
            const u32x2 mw = *(const LAS u32x2*)(lds + L_M + slot * 256 + r32 * 8);
            const unsigned w0 = mw.x >> (4 * hi), w1 = mw.y >> (4 * hi);
#pragma unroll
            for (int r = 0; r < 16; ++r) { const int c = (r & 3) + 8 * (r >> 2); if (!((w0 >> c) & 1u)) p0[r] = -INFINITY; if (!((w1 >> c) & 1u)) p1[r] = -INFINITY; }
        } else if (64 * t + 63 > wq0) {
            const int kb = 64 * t + 4 * hi;
#pragma unroll
            for (int r = 0; r < 16; ++r) { const int kv = kb + (r & 3) + 8 * (r >> 2); if (kv > qpos) p0[r] = -INFINITY; if (kv + 32 > qpos) p1[r] = -INFINITY; }
        }
        float rm = fmaxf(p0[0], p1[0]);
#pragma unroll
        for (int r = 1; r < 16; ++r) rm = fmaxf(rm, fmaxf(p0[r], p1[r]));
        rm = half_max(rm);
        const float m_new = fmaxf(m_run, rm);
        const float m_use = (m_new == -INFINITY) ? 0.f : m_new;
        const float alpha = __builtin_amdgcn_exp2f(m_run - m_use);
        float sum = 0.f;
#pragma unroll
        for (int r = 0; r < 16; ++r) { p0[r] = __builtin_amdgcn_exp2f(p0[r] - m_use); p1[r] = __builtin_amdgcn_exp2f(p1[r] - m_use); sum += p0[r] + p1[r]; }
        l_run = l_run * alpha + sum; m_run = m_new;
        if (__any(alpha != 1.0f)) {
            if (hi == 0) wsf[r32] = alpha;
            asm volatile("s_waitcnt lgkmcnt(0)" ::: "memory");
#pragma unroll
            for (int r = 0; r < 16; ++r) { const float f = wsf[crow(r, hi)]; o0[r] *= f; o1[r] *= f; }
        }
        u32x4 pw0, pw1, pw2, pw3;
        pw0 = (u32x4){pk2(p0[0], p0[1]), pk2(p0[2], p0[3]), pk2(p0[4], p0[5]), pk2(p0[6], p0[7])};
        pw1 = (u32x4){pk2(p0[8], p0[9]), pk2(p0[10], p0[11]), pk2(p0[12], p0[13]), pk2(p0[14], p0[15])};
        pw2 = (u32x4){pk2(p1[0], p1[1]), pk2(p1[2], p1[3]), pk2(p1[4], p1[5]), pk2(p1[6], p1[7])};
        pw3 = (u32x4){pk2(p1[8], p1[9]), pk2(p1[10], p1[11]), pk2(p1[12], p1[13]), pk2(p1[14], p1[15])};
        const bf16x8 pa0 = __builtin_bit_cast(bf16x8, pw0), pa1 = __builtin_bit_cast(bf16x8, pw1), pa2 = __builtin_bit_cast(bf16x8, pw2), pa3 = __builtin_bit_cast(bf16x8, pw3);
        const lds_cptr vb = (lds_cptr)lds + L_V + slot * VSLOT + ((lane >> 4) & 1) * 32 + (lane & 3) * 8 + (4 * hi + ((lane & 15) >> 2)) * 64;
#define ATT_VF(d0, ks) ({ const s16x4 lo_ = vtr(vb + (d0) * 4096 + (ks) * 1024), hi_ = vtr(vb + (d0) * 4096 + (ks) * 1024 + 512); (bf16x8){lo_[0], lo_[1], lo_[2], lo_[3], hi_[0], hi_[1], hi_[2], hi_[3]}; })
        o0 = __builtin_amdgcn_mfma_f32_32x32x16_bf16(pa0, ATT_VF(0, 0), o0, 0, 0, 0);
        o1 = __builtin_amdgcn_mfma_f32_32x32x16_bf16(pa0, ATT_VF(1, 0), o1, 0, 0, 0);
        o0 = __builtin_amdgcn_mfma_f32_32x32x16_bf16(pa1, ATT_VF(0, 1), o0, 0, 0, 0);
        o1 = __builtin_amdgcn_mfma_f32_32x32x16_bf16(pa1, ATT_VF(1, 1), o1, 0, 0, 0);
        o0 = __builtin_amdgcn_mfma_f32_32x32x16_bf16(pa2, ATT_VF(0, 2), o0, 0, 0, 0);
        o1 = __builtin_amdgcn_mfma_f32_32x32x16_bf16(pa2, ATT_VF(1, 2), o1, 0, 0, 0);
        o0 = __builtin_amdgcn_mfma_f32_32x32x16_bf16(pa3, ATT_VF(0, 3), o0, 0, 0, 0);
        o1 = __builtin_amdgcn_mfma_f32_32x32x16_bf16(pa3, ATT_VF(1, 3), o1, 0, 0, 0);
#undef ATT_VF
    }
    l_run = half_sum(l_run);
    if (hi == 0) wsf[32 + r32] = l_run;
    asm volatile("s_waitcnt lgkmcnt(0)" ::: "memory");
    {
        LAS bf16_t* stg = (LAS bf16_t*)(lds + L_OST) + wid * 2048;
#pragma unroll
        for (int r = 0; r < 16; ++r) { const int orow = crow(r, hi); const float rl = __builtin_amdgcn_rcpf(wsf[32 + orow]);
            stg[orow * 64 + r32] = (bf16_t)(pk2(o0[r] * rl, 0.f) & 0xffffu); stg[orow * 64 + 32 + r32] = (bf16_t)(pk2(o1[r] * rl, 0.f) & 0xffffu); }
        asm volatile("s_waitcnt lgkmcnt(0)" ::: "memory");
        bf16_t* Ow = P.O + (rowbase + wq0) * P.op + ocol;
#pragma unroll
        for (int i = 0; i < 4; ++i) { const int row = i * 8 + (lane >> 3), ch = lane & 7; const u32x4 v = *(const LAS u32x4*)(stg + row * 64 + ch * 8); *(u32x4*)(Ow + (long)row * P.op + ch * 8) = v; }
    }
    asm volatile("s_waitcnt lgkmcnt(0)\n\ts_barrier" ::: "memory");
#undef ATT_DMA
}
}

namespace topk {
constexpr int PITCH = 2052;
__device__ __forceinline__ unsigned fkey(float s) { const unsigned b = __float_as_uint(s + 0.0f); return b ^ ((unsigned)((int)b >> 31) | 0x80000000u); }
__device__ __forceinline__ void unit(const int tid, LAS unsigned char* lds, const bf16_t* IQ, const bf16_t* M7, unsigned* MASK, int b, int qg) {
    const int lane = tid & 63; const int wid = __builtin_amdgcn_readfirstlane(tid >> 6);
    LAS unsigned* SC = (LAS unsigned*)lds;
    const long rowbase = (long)b * SEQ; const int q0 = 16 * qg, qend = q0 + 15;
    const int nj = (qend >> 6) + 1;
    if (qend >= 256) {
        const int lq = lane & 15, lg = lane >> 4;
        bf16x8 af[4][2];
#pragma unroll
        for (int h = 0; h < 4; ++h)
#pragma unroll
            for (int ks = 0; ks < 2; ++ks) af[h][ks] = *(const bf16x8*)(IQ + (rowbase + q0 + lq) * 256 + h * 64 + 8 * lg + 32 * ks);
        float w[4][4];
#pragma unroll
        for (int i = 0; i < 4; ++i) { const u32x2 ww = *(const u32x2*)(M7 + (rowbase + q0 + 4 * lg + i) * 256 + 192); w[i][0] = bflo(ww.x); w[i][1] = bfhi(ww.x); w[i][2] = bflo(ww.y); w[i][3] = bfhi(ww.y); }
        for (int kt = wid; kt < 4 * nj; kt += 8) {
            const int key = 16 * kt + lq;
            if (16 * kt > qend) {
#pragma unroll
                for (int i = 0; i < 4; ++i) SC[(4 * lg + i) * PITCH + key] = 0u;
            } else {
                const bf16_t* kp = M7 + (rowbase + key) * 256 + 128 + 8 * lg;
                const bf16x8 b0 = *(const bf16x8*)kp, b1 = *(const bf16x8*)(kp + 32);
                f32x4 s = {0.f, 0.f, 0.f, 0.f};
#pragma unroll
                for (int h = 0; h < 4; ++h) {
                    f32x4 a = {0.f, 0.f, 0.f, 0.f};
                    a = __builtin_amdgcn_mfma_f32_16x16x32_bf16(af[h][0], b0, a, 0, 0, 0);
                    a = __builtin_amdgcn_mfma_f32_16x16x32_bf16(af[h][1], b1, a, 0, 0, 0);
#pragma unroll
                    for (int i = 0; i < 4; ++i) s[i] += fmaxf(a[i], 0.f) * w[i][h];
                }
#pragma unroll
                for (int i = 0; i < 4; ++i) { const int qpos = q0 + 4 * lg + i; SC[(4 * lg + i) * PITCH + key] = (key <= qpos) ? fkey(s[i]) : 0u; }
            }
        }
    }
    __syncthreads();
#pragma unroll 1
    for (int qq = 0; qq < 2; ++qq) {
        const int q = 2 * wid + qq, qpos = q0 + q, n = qpos + 1;
        unsigned long long mymask = 0ull;
        if (n <= 256) {
            if (lane < 32) { const int lo = 64 * lane; mymask = (qpos >= lo + 63) ? ~0ull : ((qpos < lo) ? 0ull : ((2ull << (qpos - lo)) - 1ull)); }
        } else {
            unsigned u[32];
#pragma unroll
            for (int j = 0; j < 32; ++j) u[j] = (j < nj) ? SC[q * PITCH + lane + 64 * j] : 0u;
            const int k = 256;
            unsigned T = 0u; bool exact = false;
#pragma unroll 1
            for (int bit = 31; bit >= 0; --bit) {
                const unsigned cand = T | (1u << bit);
                int cnt = 0;
#pragma unroll
                for (int j = 0; j < 32; ++j) cnt += __popcll(__ballot(u[j] >= cand));
                if (cnt >= k) { T = cand; if (cnt == k) { exact = true; break; } }
            }
            int need = 0x7fffffff;
            if (!exact) { int cgt = 0;
#pragma unroll
                for (int j = 0; j < 32; ++j) cgt += __popcll(__ballot(u[j] > T));
                need = k - cgt; }
            int prefix = 0;
#pragma unroll
            for (int j = 0; j < 32; ++j) {
                const bool eq = (u[j] == T);
                const unsigned long long eqm = __ballot(eq);
                const int rank = prefix + (int)__builtin_amdgcn_mbcnt_hi((unsigned)(eqm >> 32), __builtin_amdgcn_mbcnt_lo((unsigned)eqm, 0u));
                const bool sel = (u[j] > T) || (eq && rank < need);
                const unsigned long long sm = __ballot(sel);
                if (lane == j) mymask = sm;
                prefix += __popcll(eqm);
            }
        }
        if (lane < 32) ((unsigned long long*)(MASK + (rowbase + qpos) * 64))[lane] = mymask;
    }
    __syncthreads();
}
}

namespace rg {
__device__ __forceinline__ void unit(LAS unsigned char* lds, LAS float* CAR, const bf16_t* XY, const bf16_t* GT, const float* convw, const float* convb, const float* gab, const float* gxb, const float* lam,
                                     bf16_t* OUT, int b, int blk, const int tid) {
    const int lane = tid & 63, r32 = lane & 31, hi = lane >> 5; const int wid = __builtin_amdgcn_readfirstlane(tid >> 6);
    LAS float* R = (LAS float*)(lds + wid * 16384);
    const long rowbase = (long)b * SEQ; const int c0 = 64 * blk;
    bf16x8 Bw[2][2][4];
#pragma unroll
    for (int g = 0; g < 2; ++g)
#pragma unroll
        for (int nt = 0; nt < 2; ++nt)
#pragma unroll
            for (int ks = 0; ks < 4; ++ks) Bw[g][nt][ks] = *(const bf16x8*)(GT + (size_t)(((g * 8 + blk) * 64 + 32 * nt + r32) * 64 + 16 * ks + 8 * hi));
    float bA[2], bX[2], sp8[2];
#pragma unroll
    for (int nt = 0; nt < 2; ++nt) { const int ch = c0 + 32 * nt + r32; bA[nt] = gab[ch]; bX[nt] = gxb[ch]; sp8[nt] = 8.0f * log1pf(expf(-lam[ch])); }
    float hcar = 0.f;
    for (int chunk = 0; chunk < 8; ++chunk) {
        const int t0 = 256 * chunk + 32 * wid;
        bf16x8 af[4];
        {
            const int t = t0 + r32;
#pragma unroll
            for (int ks = 0; ks < 4; ++ks) {
                const int ch = c0 + 16 * ks + 8 * hi;
                f32x4 a0 = *(const f32x4*)(convb + ch), a1 = *(const f32x4*)(convb + ch + 4);
#pragma unroll
                for (int j = 0; j < 4; ++j) {
                    const int tt = t - 3 + j;
                    if (tt >= 0) {
                        const u32x4 xv = *(const u32x4*)(XY + (rowbase + tt) * 1024 + ch);
                        const f32x4 w0 = *(const f32x4*)(convw + j * 512 + ch), w1 = *(const f32x4*)(convw + j * 512 + ch + 4);
                        a0[0] += w0[0] * bflo(xv[0]); a0[1] += w0[1] * bfhi(xv[0]); a0[2] += w0[2] * bflo(xv[1]); a0[3] += w0[3] * bfhi(xv[1]);
                        a1[0] += w1[0] * bflo(xv[2]); a1[1] += w1[1] * bfhi(xv[2]); a1[2] += w1[2] * bflo(xv[3]); a1[3] += w1[3] * bfhi(xv[3]);
                    }
                }
                const u32x4 pk = {pk2(a0[0], a0[1]), pk2(a0[2], a0[3]), pk2(a1[0], a1[1]), pk2(a1[2], a1[3])};
                af[ks] = __builtin_bit_cast(bf16x8, pk);
                *(LAS f32x4*)(R + r32 * 68 + 16 * ks + 8 * hi) = a0; *(LAS f32x4*)(R + r32 * 68 + 16 * ks + 8 * hi + 4) = a1;
            }
        }
        asm volatile("s_waitcnt lgkmcnt(0)" ::: "memory");
        float xcC[2][16];
#pragma unroll
        for (int nt = 0; nt < 2; ++nt)
#pragma unroll
            for (int r = 0; r < 16; ++r) xcC[nt][r] = R[((r & 3) + 8 * (r >> 2) + 4 * hi) * 68 + 32 * nt + r32];
        asm volatile("s_waitcnt lgkmcnt(0)" ::: "memory");
#pragma unroll
        for (int nt = 0; nt < 2; ++nt) {
            f32x16 ga = {}, gx = {};
#pragma unroll
            for (int ks = 0; ks < 4; ++ks) { ga = __builtin_amdgcn_mfma_f32_32x32x16_bf16(af[ks], Bw[0][nt][ks], ga, 0, 0, 0); gx = __builtin_amdgcn_mfma_f32_32x32x16_bf16(af[ks], Bw[1][nt][ks], gx, 0, 0, 0); }
#pragma unroll
            for (int r = 0; r < 16; ++r) {
                const float rgt = fsigmoid(ga[r] + bA[nt]), igt = fsigmoid(gx[r] + bX[nt]);
                const float y = -rgt * sp8[nt];
                const float av = 1.0f + y * (1.0f + y * (0.5f + y * ((1.0f / 6.0f) + y * ((1.0f / 24.0f) + y * (1.0f / 120.0f)))));
                const float z = 2.0f * y;
                const float om = -z * (1.0f + z * (0.5f + z * ((1.0f / 6.0f) + z * ((1.0f / 24.0f) + z * ((1.0f / 120.0f) + z * (1.0f / 720.0f))))));
                const float uv = sqrtf(fmaxf(om, 0.f)) * (igt * xcC[nt][r]);
                const int tok = (r & 3) + 8 * (r >> 2) + 4 * hi;
                R[tok * 64 + 32 * nt + r32] = av; R[2048 + tok * 64 + 32 * nt + r32] = uv;
            }
        }
        asm volatile("s_waitcnt lgkmcnt(0)" ::: "memory");
        float hp = 0.f, Ap = 1.f;
#pragma unroll 8
        for (int t = 0; t < 32; ++t) { const float a = R[t * 64 + lane], u = R[2048 + t * 64 + lane]; hp = a * hp + u; Ap *= a; R[t * 64 + lane] = Ap; R[2048 + t * 64 + lane] = hp; }
        LAS float* car = CAR + (chunk & 1) * 1024;
        car[wid * 128 + lane] = Ap; car[wid * 128 + 64 + lane] = hp;
        __syncthreads();
        float hin = hcar, hall = hcar;
#pragma unroll
        for (int w = 0; w < 8; ++w) { const float A = car[w * 128 + lane], U = car[w * 128 + 64 + lane]; hall = A * hall + U; if (w + 1 == wid) hin = hall; }
        if (wid == 0) hin = hcar;
        hcar = hall;
#pragma unroll 8
        for (int t = 0; t < 32; ++t) {
            const float h = R[2048 + t * 64 + lane] + R[t * 64 + lane] * hin;
            const long row = rowbase + t0 + t;
            const float yv = bf2f(XY[row * 1024 + 512 + c0 + lane]);
            OUT[row * 1024 + c0 + lane] = (bf16_t)(pk2(h * gelu_tanh(yv), 0.f) & 0xffffu);
        }
        asm volatile("s_waitcnt lgkmcnt(0)" ::: "memory");
    }
    __syncthreads();
}
}

constexpr size_t MiB = 1u << 20;
constexpr size_t WS_CTL = 0, CTL_BYTES = MiB;
constexpr size_t WS_ROPE = 1 * MiB;
constexpr size_t WS_GT = 1 * MiB + 512 * 1024;
constexpr size_t WS_SSQ = 2 * MiB, WS_KR = 4 * MiB;
constexpr size_t WS_WIN = 8 * MiB, WS_WO0 = 12 * MiB, WS_W1 = 14 * MiB, WS_W2 = 30 * MiB, WS_WG = 46 * MiB, WS_WP = 50 * MiB, WS_WDN = 51 * MiB, WS_WUQ = 53 * MiB,
                 WS_WUKV = 54 * MiB + 512 * 1024, WS_WOM = 55 * MiB + 512 * 1024;
constexpr size_t WS_YF = 60 * MiB, WS_AB = 188 * MiB, WS_PB = 252 * MiB, WS_UB = 284 * MiB, WS_EB = 412 * MiB, WS_MASK = 476 * MiB, WS_END = 484 * MiB;
constexpr size_t WS_XY = WS_UB, WS_MIXED = WS_UB + 64 * MiB, WS_QD = WS_EB, WS_IQ = WS_EB + 32 * MiB, WS_M7 = WS_EB + 48 * MiB;
constexpr size_t WS_KVM = WS_UB, WS_DN = WS_EB;
constexpr int CW_BAR = 4096, CW_Q = 8192;

constexpr int LDS_GEN = 135168, LDS_AUX = LDS_GEN, LDS_MISC = LDS_AUX + 8192, LDS_BYTES = 147456;
static_assert(topk::PITCH * 16 * 4 <= LDS_GEN && att::L_END <= LDS_GEN && pg8::STAGE_BYTES <= LDS_GEN && LDS_MISC + 256 <= LDS_BYTES, "LDS map");

#define XB_TMO      128
#define XB_XCNT(j)  (256  + 64 * (j))
#define XB_XSUB(j)  (1280 + 64 * (j))
#define XB_XGEN(j)  (2304 + 64 * (j))
#define XB_TOP      3328
#define XB_TOPGEN   3392
#define XCD_BAR_WORDS 3456
#define XB_SPIN_CAP (1u << 18)
__device__ __forceinline__ unsigned xb_ld(unsigned* p)              { return __hip_atomic_load(p, __ATOMIC_RELAXED, __HIP_MEMORY_SCOPE_AGENT); }
__device__ __forceinline__ unsigned xb_add(unsigned* p, unsigned v) { return __hip_atomic_fetch_add(p, v, __ATOMIC_RELAXED, __HIP_MEMORY_SCOPE_AGENT); }
__device__ __forceinline__ unsigned xb_xcc_id() { return (unsigned)__builtin_amdgcn_s_getreg((3 << 11) | 20) & 0xFu; }
#define XB_SPIN(cond, bar) do { unsigned _sp = 0; while (cond) { __builtin_amdgcn_s_sleep(1); \
    if ((++_sp & 255u) == 0u) { if (xb_ld(&(bar)[XB_TMO])) break; if (_sp > XB_SPIN_CAP) { atomicAdd(&(bar)[XB_TMO], 1u); break; } } } } while (0)
struct XcdBarrier { unsigned* bar; unsigned x; volatile LAS unsigned* st; };
__device__ __forceinline__ XcdBarrier xcd_barrier_post(unsigned* bar, volatile LAS unsigned* st) {
    XcdBarrier b; b.bar = bar; b.x = xb_xcc_id(); b.st = st;
    if (threadIdx.x == 0) (void)xb_add(&bar[XB_XCNT(b.x)], 1u);
    return b;
}
__device__ __forceinline__ void xcd_barrier_complete(unsigned* bar, unsigned x, unsigned& nloc, unsigned& nx) {
    const unsigned G = gridDim.x * gridDim.y * gridDim.z;
    unsigned sum, cnt, mine, sp = 0u;
    for (;;) {
        sum = 0u; cnt = 0u; mine = 0u;
#pragma unroll 1
        for (unsigned j = 0; j < 16; ++j) { const unsigned c = xb_ld(&bar[XB_XCNT(j)]); sum += c; cnt += (c > 0u) ? 1u : 0u; mine = (j == x) ? c : mine; }
        if (sum == G) break;
        __builtin_amdgcn_s_sleep(1);
        if ((++sp & 255u) == 0u) { if (xb_ld(&bar[XB_TMO])) break; if (sp > XB_SPIN_CAP) { atomicAdd(&bar[XB_TMO], 1u); break; } }
    }
    nloc = mine > 0u ? mine : 1u; nx = cnt > 0u ? cnt : 1u;
}
__device__ __forceinline__ void xcd_barrier(const XcdBarrier& b) {
    asm volatile("s_waitcnt vmcnt(0)" ::: "memory");
    __syncthreads();
    if (threadIdx.x == 0) {
        unsigned* bar = b.bar; asm volatile("" : "+s"(bar));
        __builtin_amdgcn_s_waitcnt(0);
        unsigned nloc = b.st[0], nx = b.st[1];
        if (nloc == 0u) { xcd_barrier_complete(bar, b.x, nloc, nx); b.st[0] = nloc; b.st[1] = nx; }
        const unsigned old = xb_add(&bar[XB_XSUB(b.x)], 1u);
        const unsigned gen = old / nloc;
        if (old + 1u == (gen + 1u) * nloc) {
            __builtin_amdgcn_fence(__ATOMIC_RELEASE, "agent");
            asm volatile("s_waitcnt vmcnt(0)" ::: "memory");
            const unsigned og = xb_add(&bar[XB_TOP], 1u);
            const unsigned tg = og / nx;
            if (og + 1u == (tg + 1u) * nx) xb_add(&bar[XB_TOPGEN], 1u);
            else XB_SPIN(xb_ld(&bar[XB_TOPGEN]) == tg, bar);
            __builtin_amdgcn_fence(__ATOMIC_ACQUIRE, "agent");
            xb_add(&bar[XB_XGEN(b.x)], 1u);
            asm volatile("s_waitcnt vmcnt(0)" ::: "memory");
        } else {
            XB_SPIN(xb_ld(&bar[XB_XGEN(b.x)]) == gen, bar);
            __builtin_amdgcn_fence(__ATOMIC_ACQUIRE, "agent");
            asm volatile("s_waitcnt vmcnt(0)" ::: "memory");
        }
    }
    __syncthreads();
}

__device__ const double kRopeFreq[16] = {
    1.0, 0.5623413251903491, 0.31622776601683794, 0.1778279410038923, 0.1, 0.05623413251903491, 0.031622776601683791, 0.01778279410038923,
    0.01, 0.005623413251903491, 0.0031622776601683794, 0.001778279410038923, 0.001, 0.0005623413251903491, 0.00031622776601683794, 0.0001778279410038923 };
__device__ __forceinline__ void sincos_d(double x, float& s, float& c) {
    const double q = __builtin_rint(x * 0.63661977236758134308);
    double r = __builtin_fma(-q, 1.57079632679489655800e+00, x); r = __builtin_fma(-q, 6.12323399573676603587e-17, r);
    const double r2 = r * r;
    const double sp = r * (1.0 + r2 * (-1.0 / 6 + r2 * (1.0 / 120 + r2 * (-1.0 / 5040 + r2 * (1.0 / 362880 + r2 * (-1.0 / 39916800 + r2 * (1.0 / 6227020800.0)))))));
    const double cp = 1.0 + r2 * (-0.5 + r2 * (1.0 / 24 + r2 * (-1.0 / 720 + r2 * (1.0 / 40320 + r2 * (-1.0 / 3628800 + r2 * (1.0 / 479001600 + r2 * (-1.0 / 87178291200.0)))))));
    const int qi = (int)q & 3;
    const double sv = (qi == 0) ? sp : (qi == 1) ? cp : (qi == 2) ? -sp : -cp;
    const double cv = (qi == 0) ? cp : (qi == 1) ? -sp : (qi == 2) ? -cp : sp;
    s = (float)sv; c = (float)cv;
}
struct TJ { const float* W; bf16_t* dst; const float* ksc; int K, N, Npad, mode; float cs; };
__device__ __forceinline__ void transpose_item(const TJ& j, LAS float* scr, int item, int lane) {
    const int nblk = j.Npad / 32, kb = item / nblk, nb = item % nblk, k0 = 64 * kb, n0 = 32 * nb;
    const int nd = n0 + (lane & 31);
    int sc = nd; float cscale = j.cs;
    if (j.mode == 1) {
        if (nd < 1024) { sc = nd; cscale = 1.f; }
        else if (nd < 1536) { sc = nd; cscale = C2_DSA; }
        else if (nd < 1792) { sc = nd - 1536 + 1664; cscale = 1.f; }
        else if (nd < 1920) { sc = nd - 1792 + 1536; cscale = 1.f; }
        else if (nd < 1984) { sc = nd; cscale = 1.f; }
        else if (nd < 1988) { sc = nd; cscale = 0.0625f; }
        else { sc = -1; cscale = 0.f; }
    } else if (nd >= j.N) sc = -1;
#pragma unroll 8
    for (int i = 0; i < 32; ++i) { const int kk = 2 * i + (lane >> 5); float v = 0.f;
        if (sc >= 0) { v = j.W[(size_t)(k0 + kk) * j.N + sc] * cscale; if (j.ksc) v *= j.ksc[k0 + kk]; }
        scr[kk * 33 + (lane & 31)] = v; }
    asm volatile("s_waitcnt lgkmcnt(0)" ::: "memory");
    const int c = lane & 7;
#pragma unroll
    for (int jj = 0; jj < 4; ++jj) { const int n = (lane >> 3) + 8 * jj; const LAS float* s = scr + (8 * c) * 33 + n;
        u32x4 o; o.x = pk2(s[0 * 33], s[1 * 33]); o.y = pk2(s[2 * 33], s[3 * 33]); o.z = pk2(s[4 * 33], s[5 * 33]); o.w = pk2(s[6 * 33], s[7 * 33]);
        *(u32x4*)(j.dst + (size_t)(n0 + n) * j.K + k0 + 8 * c) = o; }
    asm volatile("s_waitcnt lgkmcnt(0)" ::: "memory");
}

__device__ __forceinline__ void ln_rows(const float* Y, const float* g, const float* bt, float* outF, bf16_t* outB, int gw, int NGW, int lane) {
    f32x4 gv[4], bv[4];
#pragma unroll
    for (int j = 0; j < 4; ++j) { gv[j] = *(const f32x4*)(g + (lane + 64 * j) * 4); bv[j] = *(const f32x4*)(bt + (lane + 64 * j) * 4); }
    for (int row = gw; row < TOK; row += NGW) {
        const f32x4* yr = (const f32x4*)(Y + (size_t)row * DM) + lane;
        f32x4 v[4]; float s = 0.f;
#pragma unroll
        for (int j = 0; j < 4; ++j) { v[j] = yr[64 * j]; s += (v[j][0] + v[j][1]) + (v[j][2] + v[j][3]); }
        const float mean = wave_sum(s) * (1.0f / DM); float s2 = 0.f;
#pragma unroll
        for (int j = 0; j < 4; ++j) { v[j] = v[j] - mean; s2 += (v[j][0] * v[j][0] + v[j][1] * v[j][1]) + (v[j][2] * v[j][2] + v[j][3] * v[j][3]); }
        const float rstd = 1.0f / sqrtf(wave_sum(s2) * (1.0f / DM) + 1e-5f);
#pragma unroll
        for (int j = 0; j < 4; ++j) {
            const f32x4 o = v[j] * rstd * gv[j] + bv[j];
            if (outF) *((f32x4*)(outF + (size_t)row * DM) + lane + 64 * j) = o;
            if (outB) { u32x2 w; w.x = pk2(o[0], o[1]); w.y = pk2(o[2], o[3]); *((u32x2*)(outB + (size_t)row * DM) + lane + 64 * j) = w; }
        }
    }
}

constexpr int NPH = 21;
struct Args { const float* in[25]; float* out; unsigned char* ws; int ph_lo, ph_hi; };
__device__ __forceinline__ unsigned char* fresh_ws(unsigned char* p) {
    unsigned l = __builtin_amdgcn_readfirstlane((unsigned)(uintptr_t)p), h = __builtin_amdgcn_readfirstlane((unsigned)((uintptr_t)p >> 32));
    asm volatile("" : "+s"(l), "+s"(h)); return (unsigned char*)(((uintptr_t)h << 32) | (uintptr_t)l); }
__device__ __forceinline__ const float* fresh_in(const Args& a, int k) { asm volatile("" : "+s"(k)); return a.in[k]; }

#ifndef BLKMASK
#define BLKMASK 0xfff
#endif
#define INB(tag, cond) ((((BLKMASK) >> (tag)) & 1) && (cond))
#define WSP(T, off) ((T*)(fresh_ws(args.ws) + (off)))
#define INP(k) (fresh_in(args, (k)))
template <int ph> __device__ __forceinline__ void run_phase(const Args& args, LAS unsigned char* lds, volatile LAS unsigned* MISC, const int G) {
    constexpr int L = (ph - 1) / 10, kq = (ph - 1) - 10 * L;
    int tid = threadIdx.x; asm volatile("" : "+v"(tid));
    int bx = blockIdx.x; asm volatile("" : "+s"(bx));
    const int lane = tid & 63, wave = __builtin_amdgcn_readfirstlane(tid >> 6);
    const int vcu = (G % 8 == 0) ? (bx % 8) * (G / 8) + bx / 8 : bx;
    const int gw = vcu * 8 + wave, NGW = G * 8;
    if (INB(0, ph == 0)) {
        LAS float* scr = (LAS float*)(lds + wave * 16384);
        unsigned char* wsl = fresh_ws(args.ws);
        for (int jb = 0; jb < 14; ++jb) {
            TJ j; j.ksc = nullptr; j.mode = 0; j.cs = 1.f;
            int wi = 0; size_t woff = 0, doff = 0;
            switch (jb) {
                case 0:  wi = 10; doff = WS_WIN; j.K = 1024; j.N = 1988; j.Npad = 2048; j.mode = 1; break;
                case 1:  wi = 18; doff = WS_WO0; j.K = 1024; j.N = 1024; j.Npad = 1024; break;
                case 2:  wi = 6; doff = WS_W1; j.K = 1024; j.N = 4096; j.Npad = 4096; break;
                case 3:  wi = 6; woff = (size_t)1024 * 4096; doff = WS_W1 + (size_t)4096 * 1024 * 2; j.K = 1024; j.N = 4096; j.Npad = 4096; break;
                case 4:  wi = 7; doff = WS_W2; j.K = 4096; j.N = 1024; j.Npad = 1024; break;
                case 5:  wi = 7; woff = (size_t)4096 * 1024; doff = WS_W2 + (size_t)1024 * 4096 * 2; j.K = 4096; j.N = 1024; j.Npad = 1024; break;
                case 6:  wi = 9; doff = WS_WG; j.K = 1024; j.N = 1024; j.Npad = 1024; break;
                case 7:  wi = 9; woff = (size_t)1024 * 1024; doff = WS_WG + (size_t)1024 * 1024 * 2; j.K = 1024; j.N = 1024; j.Npad = 1024; break;
                case 8:  wi = 8; doff = WS_WP; j.K = 256; j.N = 1024; j.Npad = 1024; break;
                case 9:  wi = 8; woff = (size_t)256 * 1024; doff = WS_WP + (size_t)1024 * 256 * 2; j.K = 256; j.N = 1024; j.Npad = 1024; break;
                case 10: wi = 19; doff = WS_WDN; j.K = 1024; j.N = 800; j.Npad = 1024; break;
                case 11: wi = 22; doff = WS_WUQ; j.K = 512; j.N = 1536; j.Npad = 1536; j.cs = C2_MLA; break;
                case 12: wi = 23; doff = WS_WUKV; j.K = 256; j.N = 2048; j.Npad = 2048; break;
                default: wi = 24; doff = WS_WOM; j.K = 1024; j.N = 1024; j.Npad = 1024; break;
            }
            j.W = INP(wi) + woff; j.dst = (bf16_t*)(wsl + doff);
            if (jb == 11) j.ksc = INP(20);
            if (jb == 12) j.ksc = INP(21);
            const int nitems = (j.K / 64) * (j.Npad / 32);
            for (int it = gw; it < nitems; it += NGW) transpose_item(j, scr, it, lane);
        }
        {
            const float* x = INP(0); bf16_t* AB = (bf16_t*)(wsl + WS_AB);
            for (int row = gw; row < TOK; row += NGW) {
                const f32x4* xr = (const f32x4*)(x + (size_t)row * DM) + lane;
#pragma unroll
                for (int j = 0; j < 4; ++j) { const f32x4 v = xr[64 * j]; u32x2 w; w.x = pk2(v[0], v[1]); w.y = pk2(v[2], v[3]); *((u32x2*)(AB + (size_t)row * DM) + lane + 64 * j) = w; }
            }
        }
        {
            const float* pin = INP(1); bf16_t* PB = (bf16_t*)(wsl + WS_PB);
            for (int row = gw; row < 2 * TOK; row += NGW) {
                const f32x4 v = *((const f32x4*)(pin + (size_t)row * 256) + lane); u32x2 w; w.x = pk2(v[0], v[1]); w.y = pk2(v[2], v[3]); *((u32x2*)(PB + (size_t)row * 256) + lane) = w;
            }
        }
        { float* ropeC = (float*)(wsl + WS_ROPE); float* ropeS = ropeC + SEQ * 16;
          for (int e = gw * 64 + lane; e < SEQ * 16; e += NGW * 64) { float s, c; sincos_d((double)(e >> 4) * kRopeFreq[e & 15], s, c); ropeC[e] = c; ropeS[e] = s; } }
        { bf16_t* GT = (bf16_t*)(wsl + WS_GT); const float* Wa = INP(13); const float* Wx = INP(15);
          for (int e = gw * 64 + lane; e < 65536; e += NGW * 64) { const int g = e >> 15, blk = (e >> 12) & 7, d = (e >> 6) & 63, c = e & 63;
            const float* Wsrc = g ? Wx : Wa; GT[e] = (bf16_t)(pk2(Wsrc[(blk * 64 + c) * 64 + d], 0.f) & 0xffffu); } }
    }
    if (ph >= 1) {
        if (L == 0) {
            if (INB(1, kq == 0)) {
                unsigned char* wsl = fresh_ws(args.ws);
                pg8::Gemm g{(bf16_t*)(wsl + WS_AB), (bf16_t*)(wsl + WS_WIN), TOK, 2048, 1024, 1024}; pg8::StaticOrder S; S.init(TOK, 2048, G, bx);
                pg8::EpiBf<0, 1, 0> E{(bf16_t*)(wsl + WS_XY), 1024, (bf16_t*)(wsl + WS_QD), (bf16_t*)(wsl + WS_IQ), (bf16_t*)(wsl + WS_M7), nullptr};
                pg8::gemm_phase<pg8::EpiBf<0, 1, 0>, pg8::StaticOrder, true, true>(tid, lds, g, S, E);
            }
            if (INB(2, kq == 1)) {
                unsigned char* wsl = fresh_ws(args.ws);
                unsigned* ctl = (unsigned*)(wsl + WS_CTL);
                bf16_t* XY = (bf16_t*)(wsl + WS_XY); bf16_t* MIXED = (bf16_t*)(wsl + WS_MIXED); bf16_t* IQ = (bf16_t*)(wsl + WS_IQ); bf16_t* M7 = (bf16_t*)(wsl + WS_M7);
                bf16_t* GT = (bf16_t*)(wsl + WS_GT); unsigned* MASK = (unsigned*)(wsl + WS_MASK);
                for (;;) {
                    if (tid == 0) MISC[0] = atomicAdd(ctl + CW_Q, 1u);
                    __syncthreads();
                    const int un = (int)MISC[0];
                    __syncthreads();
                    if (un >= 128 + 2048) break;
                    if (un < 128) rg::unit(lds, (LAS float*)(lds + LDS_AUX), XY, GT, INP(11), INP(12), INP(14), INP(16), INP(17), MIXED, un >> 3, un & 7, tid);
                    else { const int i = un - 128; topk::unit(tid, lds, IQ, M7, MASK, i & 15, 127 - (i >> 4)); }
                }
            }
            if (INB(3, kq == 2)) {
                unsigned char* wsl = fresh_ws(args.ws);
                bf16_t* M7 = (bf16_t*)(wsl + WS_M7);
                att::AttnP P{(bf16_t*)(wsl + WS_QD), 512, M7, 256, nullptr, M7, 256, (bf16_t*)(wsl + WS_MIXED) + 512, 1024, (unsigned*)(wsl + WS_MASK)};
                for (int v = vcu; v < 256; v += G) {
                    const int b = v >> 4, s = v & 15;
#pragma unroll 1
                    for (int i = 0; i < 4; ++i) { const int qb = (i == 0) ? 63 - s : (i == 1) ? 32 + s : (i == 2) ? 31 - s : s; att::attn_unit<8, true>(tid, lds, P, b, 0, 32 * qb, (qb >> 1) + 1); }
                }
            }
        } else {
            if (INB(4, kq == 0)) {
                unsigned char* wsl = fresh_ws(args.ws);
                pg8::Gemm g{(bf16_t*)(wsl + WS_AB), (bf16_t*)(wsl + WS_WDN), TOK, 1024, 1024, 1024}; pg8::StaticOrder S; S.init(TOK, 1024, G, bx);
                pg8::EpiDown E{(bf16_t*)(wsl + WS_DN), (bf16_t*)(wsl + WS_KR), (float*)(wsl + WS_SSQ), (float*)(wsl + WS_ROPE), (float*)(wsl + WS_ROPE) + SEQ * 16};
                pg8::gemm_phase<pg8::EpiDown, pg8::StaticOrder, true, true>(tid, lds, g, S, E);
            }
            if (INB(5, kq == 1)) {
                { unsigned char* wsl = fresh_ws(args.ws);
                  pg8::Gemm g{(bf16_t*)(wsl + WS_DN), (bf16_t*)(wsl + WS_WUQ), TOK, 1536, 512, 1024}; pg8::StaticOrder S; S.init(TOK, 1536, G, bx);
                  pg8::EpiUq E{(bf16_t*)args.out, (float*)(wsl + WS_SSQ), (float*)(wsl + WS_ROPE), (float*)(wsl + WS_ROPE) + SEQ * 16};
                  pg8::gemm_phase<pg8::EpiUq, pg8::StaticOrder, true, true>(tid, lds, g, S, E); }
                { unsigned char* wsl = fresh_ws(args.ws);
                  pg8::Gemm g{(bf16_t*)(wsl + WS_DN) + 512, (bf16_t*)(wsl + WS_WUKV), TOK, 2048, 256, 1024}; pg8::StaticOrder S; S.init(TOK, 2048, G, bx);
                  pg8::EpiBf<0, 0, 1> E{(bf16_t*)(wsl + WS_KVM), 2048, nullptr, nullptr, nullptr, (float*)(wsl + WS_SSQ)};
                  pg8::gemm_phase<pg8::EpiBf<0, 0, 1>, pg8::StaticOrder, true, true>(tid, lds, g, S, E); }
            }
            if (INB(6, kq == 2)) {
                unsigned char* wsl = fresh_ws(args.ws);
                bf16_t* KVM = (bf16_t*)(wsl + WS_KVM);
                att::AttnP P{(bf16_t*)args.out, 1536, KVM, 2048, (bf16_t*)(wsl + WS_KR), KVM, 2048, (bf16_t*)(wsl + WS_DN), 1024, nullptr};
                for (int v = vcu; v < 256; v += G) {
#pragma unroll 1
                    for (int qb = 7; qb >= 0; --qb) att::attn_unit<12, false>(tid, lds, P, v >> 4, v & 15, 256 * qb, 4 * (qb + 1));
                }
            }
        }
        if (INB(7, kq == 3)) {
            unsigned char* wsl = fresh_ws(args.ws);
            float* YF = (float*)(wsl + WS_YF);
            pg8::Gemm g{(bf16_t*)(wsl + (L == 0 ? WS_MIXED : WS_DN)), (bf16_t*)(wsl + (L == 0 ? WS_WO0 : WS_WOM)), TOK, 1024, 1024, 1024}; pg8::StaticOrder S; S.init(TOK, 1024, G, bx);
            pg8::EpiRes E{L == 0 ? INP(0) : (const float*)YF, YF, nullptr, DN_ALPHA};
            pg8::gemm_phase<pg8::EpiRes, pg8::StaticOrder, true, true>(tid, lds, g, S, E);
        }
        if (INB(8, kq == 4)) { unsigned char* wsl = fresh_ws(args.ws); ln_rows((float*)(wsl + WS_YF), INP(2) + L * DM, INP(3) + L * DM, args.out, (bf16_t*)(wsl + WS_AB), gw, NGW, lane); }
        {
            constexpr int hf = (kq == 7 || kq == 8) ? 1 : 0;
            if (INB(9, kq == 5 || kq == 7)) {
                { unsigned char* wsl = fresh_ws(args.ws);
                  pg8::Gemm g{(bf16_t*)(wsl + WS_AB) + (size_t)hf * HALF_TOK * DM, (bf16_t*)(wsl + WS_W1) + (size_t)L * DFF * DM, HALF_TOK, DFF, DM, DM}; pg8::StaticOrder S; S.init(HALF_TOK, DFF, G, bx);
                  pg8::EpiBf<1, 0, 0> E{(bf16_t*)(wsl + WS_UB), DFF, nullptr, nullptr, nullptr, nullptr};
                  pg8::gemm_phase<pg8::EpiBf<1, 0, 0>, pg8::StaticOrder, true, true>(tid, lds, g, S, E); }
                if (hf == 0) {
                    { unsigned char* wsl = fresh_ws(args.ws);
                      pg8::Gemm g{(bf16_t*)(wsl + WS_PB) + (size_t)L * TOK * 256, (bf16_t*)(wsl + WS_WP) + (size_t)L * DM * 256, TOK, DM, 256, 256}; pg8::StaticOrder S; S.init(TOK, DM, G, bx);
                      pg8::EpiBf<0, 0, 0> E{(bf16_t*)(wsl + WS_EB), DM, nullptr, nullptr, nullptr, nullptr};
                      pg8::gemm_phase<pg8::EpiBf<0, 0, 0>, pg8::StaticOrder, true, true>(tid, lds, g, S, E); }
                    { unsigned char* wsl = fresh_ws(args.ws);
                      pg8::Gemm g{(bf16_t*)(wsl + WS_AB), (bf16_t*)(wsl + WS_WG) + (size_t)L * DM * DM, TOK, DM, DM, DM}; pg8::StaticOrder S; S.init(TOK, DM, G, bx);
                      pg8::EpiBf<2, 0, 0> E{(bf16_t*)(wsl + WS_EB), DM, nullptr, nullptr, nullptr, nullptr};
                      pg8::gemm_phase<pg8::EpiBf<2, 0, 0>, pg8::StaticOrder, true, true>(tid, lds, g, S, E); }
                }
            }
            if (INB(10, kq == 6 || kq == 8)) {
                const size_t ro = (size_t)hf * HALF_TOK * DM;
                unsigned char* wsl = fresh_ws(args.ws);
                pg8::Gemm g{(bf16_t*)(wsl + WS_UB), (bf16_t*)(wsl + WS_W2) + (size_t)L * DM * DFF, HALF_TOK, DM, DFF, DFF}; pg8::StaticOrder S; S.init(HALF_TOK, DM, G, bx);
                pg8::EpiRes E{args.out + ro, (float*)(wsl + WS_YF) + ro, (bf16_t*)(wsl + WS_EB) + ro, DN_ALPHA};
                pg8::gemm_phase<pg8::EpiRes, pg8::StaticOrder, true, true>(tid, lds, g, S, E);
            }
        }
        if (INB(11, kq == 9)) {
            unsigned char* wsl = fresh_ws(args.ws); float* YF = (float*)(wsl + WS_YF);
            if (L == 0) ln_rows(YF, INP(4), INP(5), YF, (bf16_t*)(wsl + WS_AB), gw, NGW, lane);
            else ln_rows(YF, INP(4) + DM, INP(5) + DM, args.out, nullptr, gw, NGW, lane);
        }
    }
}
#undef INB
#undef WSP
#undef INP

__global__ void __launch_bounds__(512, 2) fwd_kernel(Args args) {
    extern __shared__ __attribute__((aligned(16))) unsigned char lds_raw[];
    LAS unsigned char* lds = (LAS unsigned char*)lds_raw;
    volatile LAS unsigned* MISC = (volatile LAS unsigned*)(lds + LDS_MISC);
    const int G = gridDim.x;
    unsigned* ctl = (unsigned*)(args.ws + WS_CTL);
    for (int u = threadIdx.x; u < 64; u += 512) MISC[u] = 0u;
    __syncthreads();
    XcdBarrier bar; bar.bar = ctl + CW_BAR; bar.x = 0; bar.st = nullptr;
#if !MK_SPLIT
    bar = xcd_barrier_post(ctl + CW_BAR, MISC + 8);
#endif
    const int lo = args.ph_lo, hi = args.ph_hi;
#define RUN(PH) if (lo <= PH && PH < hi) { run_phase<PH>(args, lds, MISC, G); if (PH + 1 < hi) xcd_barrier(bar); }
    RUN(0) RUN(1) RUN(2) RUN(3) RUN(4) RUN(5) RUN(6) RUN(7) RUN(8) RUN(9) RUN(10)
    RUN(11) RUN(12) RUN(13) RUN(14) RUN(15) RUN(16) RUN(17) RUN(18) RUN(19) RUN(20)
#undef RUN
}


extern "C" void kernel_launch(void* const* d_in, const int* in_sizes, int n_in, void* d_out, int out_size, void* d_ws, size_t ws_size, hipStream_t stream) {
    static int grid = 0;
    if (grid == 0) {
        if (n_in != 25 || out_size != TOK * DM || ws_size < WS_END) { fprintf(stderr, "kernel_launch: unexpected problem (n_in %d, out %d, ws %zu; need ws >= %zu); nothing launched\n", n_in, out_size, ws_size, (size_t)WS_END); grid = -1; return; }
        int dev = 0, cus = 0;
        if (hipGetDevice(&dev) != hipSuccess || hipDeviceGetAttribute(&cus, hipDeviceAttributeMultiprocessorCount, dev) != hipSuccess) { fprintf(stderr, "kernel_launch: device query failed\n"); grid = -1; return; }
        if (hipFuncSetAttribute((const void*)fwd_kernel, hipFuncAttributeMaxDynamicSharedMemorySize, LDS_BYTES) != hipSuccess) { fprintf(stderr, "kernel_launch: hipFuncSetAttribute failed\n"); grid = -1; return; }
        int per_cu = 0;
        if (hipOccupancyMaxActiveBlocksPerMultiprocessor(&per_cu, (const void*)fwd_kernel, 512, LDS_BYTES) != hipSuccess || per_cu < 1) fprintf(stderr, "kernel_launch: note: occupancy query reports %d blocks/CU\n", per_cu);
        (void)hipGetLastError();
        grid = cus;
    }
    if (grid < 0) return;
    if (hipMemsetAsync((char*)d_ws + WS_CTL, 0, CTL_BYTES, stream) != hipSuccess) { fprintf(stderr, "kernel_launch: memset failed\n"); return; }
    Args a{};
    for (int i = 0; i < 25; ++i) a.in[i] = (const float*)d_in[i];
    a.out = (float*)d_out; a.ws = (unsigned char*)d_ws;
#if MK_SPLIT
    for (int p = 0; p < NPH; ++p) { a.ph_lo = p; a.ph_hi = p + 1; hipLaunchKernelGGL(fwd_kernel, dim3(grid), dim3(512), LDS_BYTES, stream, a); }
#else
    a.ph_lo = 0; a.ph_hi = NPH;
    hipLaunchKernelGGL(fwd_kernel, dim3(grid), dim3(512), LDS_BYTES, stream, a);
#endif
    const hipError_t le = hipPeekAtLastError();
    if (le != hipSuccess) fprintf(stderr, "kernel_launch: launch failed: %s\n", hipGetErrorName(le));
}
```
